# Optimizing an MI355X kernel written in HIP

```python
import jax, jax.numpy as jnp
from jax import lax
import numpy as np

D_MODEL = 1024
BATCH = 2
SEQ = 8192
DEPTH = 2

N_META = 16
CONV_WIDTH = 3
N_HEADS = 16
HEAD_DIM = 64
N_KV_HEADS = 4
Q_PER_KV = N_HEADS // N_KV_HEADS
WINDOW = 128
BLOCK = 128
ROPE_THETA = 10000.0
N_GROUPS = 4
EXPERTS_PER_GROUP = 8
N_EXPERTS = N_GROUPS * EXPERTS_PER_GROUP
TOP_K = 2
D_EXPERT = 256
N_A_LAYERS = DEPTH // 2
N_B_LAYERS = DEPTH - N_A_LAYERS
NORM_EPS = 1e-5
NEG_INF = -1e30

kernel_name = "yoco_shortconv_swa_sink_hier_moe"


def rms_norm(x, g):
    xf = x.astype(jnp.float32)
    y = xf * lax.rsqrt(jnp.mean(xf * xf, axis=-1, keepdims=True) + NORM_EPS)
    return (y * g.astype(jnp.float32)).astype(x.dtype)


def rope(x, pos):
    half = HEAD_DIM // 2
    inv_freq = ROPE_THETA ** (-jnp.arange(half, dtype=jnp.float32) / half)
    ang = pos.astype(jnp.float32)[:, None] * inv_freq[None, :]
    cos = jnp.cos(ang)[None, :, None, :]
    sin = jnp.sin(ang)[None, :, None, :]
    xf = x.astype(jnp.float32)
    x1, x2 = xf[..., :half], xf[..., half:]
    out = jnp.concatenate([x1 * cos - x2 * sin, x2 * cos + x1 * sin], axis=-1)
    return out.astype(x.dtype)


def short_conv_mixer(xn, w_in, conv_w, w_out):
    gate_b, gate_c, v = jnp.split(xn @ w_in, 3, axis=-1)
    u = gate_c * v
    L = u.shape[1]
    up = jnp.pad(u, ((0, 0), (CONV_WIDTH - 1, 0), (0, 0)))
    conv = up[:, 0:L] * conv_w[0]
    for i in range(1, CONV_WIDTH):
        conv = conv + up[:, i:i + L] * conv_w[i]
    return (gate_b * conv) @ w_out


def _to_blocks(t, pad):
    widths = [(0, 0), (pad, 0)] + [(0, 0)] * (t.ndim - 2)
    t = jnp.pad(t, widths)
    return t.reshape((t.shape[0], t.shape[1] // BLOCK, BLOCK) + t.shape[2:])


def _band(tb):
    widths = [(0, 0), (1, 0)] + [(0, 0)] * (tb.ndim - 2)
    prev = jnp.pad(tb[:, :-1], widths)
    return jnp.concatenate([prev, tb], axis=2)


def shared_kv(h, kv_norm_g, w_kv, pos):
    B, L, _ = h.shape
    pad = (-L) % BLOCK
    k, v = jnp.split(rms_norm(h, kv_norm_g) @ w_kv, 2, axis=-1)
    k = rope(k.reshape(B, L, N_KV_HEADS, HEAD_DIM), pos)
    v = v.reshape(B, L, N_KV_HEADS, HEAD_DIM)
    return _band(_to_blocks(k, pad)), _band(_to_blocks(v, pad))


def sliding_window_attention(xn, w_q, w_o, sinks, k_band, v_band, pos):
    B, L, _ = xn.shape
    pad = (-L) % BLOCK
    n_blk = (L + pad) // BLOCK
    q = rope((xn @ w_q).reshape(B, L, N_HEADS, HEAD_DIM), pos)
    q = _to_blocks(q, pad).reshape(B, n_blk, BLOCK, N_KV_HEADS, Q_PER_KV, HEAD_DIM)
    s = jnp.einsum('bnqkgd,bnjkd->bnkgqj', q, k_band,
                   preferred_element_type=jnp.float32) * (HEAD_DIM ** -0.5)
    qi = jnp.arange(BLOCK)[:, None]
    kj = jnp.arange(2 * BLOCK)[None, :]
    diff = qi - kj + BLOCK
    band = (diff >= 0) & (diff < WINDOW)
    kpos = (jnp.arange(n_blk)[:, None] - 1) * BLOCK + kj - pad
    valid = band[None] & (kpos >= 0)[:, None, :]
    s = jnp.where(valid[None, :, None, None], s, NEG_INF)
    sink = jnp.broadcast_to(
        sinks.astype(jnp.float32).reshape(1, 1, N_KV_HEADS, Q_PER_KV, 1, 1),
        s.shape[:-1] + (1,))
    p = jax.nn.softmax(jnp.concatenate([s, sink], axis=-1), axis=-1)[..., :-1]
    o = jnp.einsum('bnkgqj,bnjkd->bnqkgd', p.astype(v_band.dtype), v_band)
    o = o.reshape(B, n_blk * BLOCK, N_HEADS * HEAD_DIM)[:, pad:]
    return o @ w_o


def hierarchical_moe(xn, rg_w, rg_b, re_w, re_b, w_gate, w_up, w_down):
    shape = xn.shape
    t = xn.reshape(-1, shape[-1])
    T = t.shape[0]
    g_logits = (t @ rg_w + rg_b).astype(jnp.float32)
    g_idx = jnp.argmax(g_logits, axis=-1)
    g_w = jnp.take_along_axis(jax.nn.softmax(g_logits, axis=-1), g_idx[:, None], axis=-1)
    e_logits = (t @ re_w + re_b).astype(jnp.float32).reshape(T, N_GROUPS, EXPERTS_PER_GROUP)
    e_sel = jnp.take_along_axis(e_logits, g_idx[:, None, None], axis=1)[:, 0]
    top_v, top_i = lax.top_k(e_sel, TOP_K)
    top_w = jax.nn.softmax(top_v, axis=-1) * g_w
    expert_id = g_idx[:, None] * EXPERTS_PER_GROUP + top_i
    combine = jnp.sum(jax.nn.one_hot(expert_id, N_EXPERTS, dtype=jnp.float32)
                      * top_w[..., None], axis=1).astype(t.dtype)
    out = jnp.zeros_like(t)
    for e in range(N_EXPERTS):
        hdn = jax.nn.silu(t @ w_gate[e]) * (t @ w_up[e])
        out = out + (hdn * combine[:, e:e + 1]) @ w_down[e]
    return out.reshape(shape)


def setup_inputs(seed: int = 0) -> dict:
    key = jax.random.key(seed)
    ks = jax.random.split(key, 21)
    D, F, E, G = D_MODEL, D_EXPERT, N_EXPERTS, N_GROUPS
    nrm = lambda k, s, sc: jax.random.normal(k, s, jnp.float32) * sc
    gain = lambda k, s: 1.0 + 0.02 * jax.random.normal(k, s, jnp.float32)
    return {
        "x": nrm(ks[0], (BATCH, SEQ, D), 1.0),
        "meta_tokens": nrm(ks[1], (N_META, D), 1.0),
        "conv_norm_g": gain(ks[2], (N_A_LAYERS, D)),
        "conv_w_in": nrm(ks[3], (N_A_LAYERS, D, 3 * D), D ** -0.5),
        "conv_w": nrm(ks[4], (N_A_LAYERS, CONV_WIDTH, D), CONV_WIDTH ** -0.5),
        "conv_w_out": nrm(ks[5], (N_A_LAYERS, D, D), D ** -0.5),
        "kv_norm_g": gain(ks[6], (D,)),
        "w_kv": nrm(ks[7], (D, 2 * N_KV_HEADS * HEAD_DIM), D ** -0.5),
        "attn_norm_g": gain(ks[8], (N_B_LAYERS, D)),
        "w_q": nrm(ks[9], (N_B_LAYERS, D, N_HEADS * HEAD_DIM), D ** -0.5),
        "w_o": nrm(ks[10], (N_B_LAYERS, N_HEADS * HEAD_DIM, D), (N_HEADS * HEAD_DIM) ** -0.5),
        "sinks": nrm(ks[11], (N_B_LAYERS, N_HEADS), 0.5),
        "ffn_norm_g": gain(ks[12], (DEPTH, D)),
        "router_group_w": nrm(ks[13], (DEPTH, D, G), D ** -0.5),
        "router_group_b": nrm(ks[14], (DEPTH, G), 0.01),
        "router_expert_w": nrm(ks[15], (DEPTH, D, E), D ** -0.5),
        "router_expert_b": nrm(ks[16], (DEPTH, E), 0.01),
        "w_gate": nrm(ks[17], (DEPTH, E, D, F), D ** -0.5),
        "w_up": nrm(ks[18], (DEPTH, E, D, F), D ** -0.5),
        "w_down": nrm(ks[19], (DEPTH, E, F, D), F ** -0.5),
        "final_norm_g": gain(ks[20], (D,)),
    }


def reference(x, meta_tokens, conv_norm_g, conv_w_in, conv_w, conv_w_out, kv_norm_g, w_kv,
              attn_norm_g, w_q, w_o, sinks, ffn_norm_g, router_group_w, router_group_b,
              router_expert_w, router_expert_b, w_gate, w_up, w_down, final_norm_g):
    B = x.shape[0]
    meta = jnp.broadcast_to(meta_tokens.astype(x.dtype)[None], (B, N_META, x.shape[-1]))
    h = jnp.concatenate([meta, x], axis=1)
    pos = jnp.arange(h.shape[1], dtype=jnp.int32)
    k_band, v_band = None, None
    for layer in range(DEPTH):
        if layer < N_A_LAYERS:
            i = layer
            h = h + short_conv_mixer(rms_norm(h, conv_norm_g[i]), conv_w_in[i], conv_w[i], conv_w_out[i])
        else:
            j = layer - N_A_LAYERS
            if j == 0:
                k_band, v_band = shared_kv(h, kv_norm_g, w_kv, pos)
            h = h + sliding_window_attention(rms_norm(h, attn_norm_g[j]), w_q[j], w_o[j], sinks[j],
                                             k_band, v_band, pos)
        h = h + hierarchical_moe(rms_norm(h, ffn_norm_g[layer]), router_group_w[layer],
                                 router_group_b[layer], router_expert_w[layer], router_expert_b[layer],
                                 w_gate[layer], w_up[layer], w_down[layer])
    h = rms_norm(h, final_norm_g)
    return h[:, N_META:]
```

```cpp
#include <hip/hip_runtime.h>
#include <cstdio>
#include <cstdint>
#include <cmath>

#define LAS __attribute__((address_space(3)))
#define GAS __attribute__((address_space(1)))
typedef unsigned short bf16;
typedef short bf16x8 __attribute__((ext_vector_type(8)));
typedef short s16x4 __attribute__((ext_vector_type(4)));
typedef float f32x2 __attribute__((ext_vector_type(2)));
typedef float f32x4 __attribute__((ext_vector_type(4)));
typedef float f32x16 __attribute__((ext_vector_type(16)));
typedef unsigned u32x2 __attribute__((ext_vector_type(2)));
typedef unsigned u32x4 __attribute__((ext_vector_type(4)));

constexpr int D = 1024, SEQ = 8192, BATCH = 2, NMETA = 16;
constexpr int MX = BATCH * SEQ;
constexpr int MR = MX + NMETA;
constexpr int NH = 16, HD = 64, NKV = 4;
constexpr int NE = 32, EPG = 8, FE = 256;
constexpr int KVROWS = SEQ + 128;
constexpr int LPOS = SEQ + NMETA;
constexpr float EPS = 1e-5f;
constexpr float LOG2E = 1.4426950408889634f;
constexpr float QSCALE = 0.125f * LOG2E;
constexpr int MAXTILES = 160;
constexpr int LCAP = MR;

constexpr size_t MiB = 1u << 20;
constexpr size_t WS_CTL = 0, CTL_ZERO_BYTES = 1 * MiB;
constexpr size_t WS_ROPE = 1 * MiB;
constexpr size_t WS_ROUTER = 4 * MiB;
constexpr size_t WS_LIST = 5 * MiB;
constexpr size_t WS_POS = 8 * MiB;
constexpr size_t WS_TOPW = 8 * MiB + 256 * 1024;
constexpr size_t WS_HM = 8 * MiB + 512 * 1024;
constexpr size_t WS_WIN = 10 * MiB, WS_WOUT = 16 * MiB, WS_WQKV = 18 * MiB, WS_WO = 21 * MiB;
constexpr size_t WS_WMOE = 24 * MiB;
constexpr size_t WMOE_LAYER = 48 * MiB, WMOE_EXPERT = 1536 * 1024, WMOE_PART = 512 * 1024;
constexpr size_t WS_SB = 120 * MiB;
constexpr size_t WS_SC = 153 * MiB;
constexpr size_t WS_KV = 186 * MiB;
constexpr size_t WS_Y = 120 * MiB;
constexpr size_t WS_SA = 203 * MiB;
constexpr size_t WS_HDN = 236 * MiB;
constexpr size_t WS_END = 256 * MiB;
constexpr size_t KV_BYTES = (size_t)BATCH * KVROWS * 256 * 2;
static_assert(WS_Y + (size_t)MAXTILES * 256 * 1024 * 2 <= WS_SA && WS_KV + 2 * KV_BYTES <= WS_SA && WS_HDN + (size_t)MAXTILES * 256 * 256 * 2 <= WS_END, "ws map");
constexpr int CW_BAR = 4096;
constexpr int CW_CNT = 16384;

constexpr int RING_BYTES = 131072;
constexpr int MISC_OFF = RING_BYTES + 320;
constexpr int TILETAB_OFF = RING_BYTES + 1024;
constexpr int LDS_BYTES = 147456;

typedef GAS unsigned gu32;
#define RLX_AGENT __ATOMIC_RELAXED, __HIP_MEMORY_SCOPE_AGENT
#define LDS_WAIT() asm volatile("s_waitcnt lgkmcnt(0)" ::: "memory")
#define VM_WAIT() asm volatile("s_waitcnt vmcnt(0)" ::: "memory")
__device__ __forceinline__ unsigned f2bf(float f) { unsigned u = __builtin_bit_cast(unsigned, f); return (u + 0x7fffu + ((u >> 16) & 1u)) >> 16; }
__device__ __forceinline__ float bf2f(unsigned h) { return __builtin_bit_cast(float, h << 16); }
typedef __bf16 bf16x2_t __attribute__((ext_vector_type(2)));
__device__ __forceinline__ unsigned pk2(float lo, float hi) { f32x2 v = {lo, hi}; bf16x2_t b = __builtin_convertvector(v, bf16x2_t); return __builtin_bit_cast(unsigned, b); }
__device__ __forceinline__ float wave_sum(float v) {
#pragma unroll
    for (int o = 1; o < 64; o <<= 1) v += __shfl_xor(v, o);
    return v;
}
__device__ __forceinline__ void store8bf(bf16* p, f32x4 v0, f32x4 v1) { u32x4 w; w.x = pk2(v0[0], v0[1]); w.y = pk2(v0[2], v0[3]); w.z = pk2(v1[0], v1[1]); w.w = pk2(v1[2], v1[3]); *(u32x4*)p = w; }
__device__ __forceinline__ void store4bf(bf16* p, f32x4 v) { u32x2 w; w.x = pk2(v[0], v[1]); w.y = pk2(v[2], v[3]); *(u32x2*)p = w; }

#define XB_TMO      128
#define XB_XCNT(j)  (256  + 64 * (j))
#define XB_XSUB(j)  (1280 + 64 * (j))
#define XB_XGEN(j)  (2304 + 64 * (j))
#define XB_TOP      3328
#define XB_TOPGEN   3392
#define XCD_BAR_WORDS 3456
#define XB_SPIN_CAP (1u << 18)
__device__ __forceinline__ unsigned xb_ld(unsigned* p)              { return __hip_atomic_load(p, __ATOMIC_RELAXED, __HIP_MEMORY_SCOPE_AGENT); }
__device__ __forceinline__ unsigned xb_add(unsigned* p, unsigned v) { return __hip_atomic_fetch_add(p, v, __ATOMIC_RELAXED, __HIP_MEMORY_SCOPE_AGENT); }
__device__ __forceinline__ unsigned xb_xcc_id() { return (unsigned)__builtin_amdgcn_s_getreg((3 << 11) | 20) & 0xFu; }
#define XB_SPIN(cond, bar) do { unsigned _sp = 0; while (cond) { __builtin_amdgcn_s_sleep(1); \
    if ((++_sp & 255u) == 0u) { if (xb_ld(&(bar)[XB_TMO])) break; if (_sp > XB_SPIN_CAP) { atomicAdd(&(bar)[XB_TMO], 1u); break; } } } } while (0)
struct XcdBarrier { unsigned* bar; unsigned x; volatile LAS unsigned* st; };
__device__ __forceinline__ XcdBarrier xcd_barrier_post(unsigned* bar, volatile LAS unsigned* st) {
    XcdBarrier b; b.bar = bar; b.x = xb_xcc_id(); b.st = st;
    if (threadIdx.x == 0) (void)xb_add(&bar[XB_XCNT(b.x)], 1u);
    return b;
}
__device__ __forceinline__ void xcd_barrier_complete(unsigned* bar, unsigned x, unsigned& nloc, unsigned& nx) {
    const unsigned G = gridDim.x * gridDim.y * gridDim.z;
    unsigned sum, cnt, mine, sp = 0u;
    for (;;) {
        sum = 0u; cnt = 0u; mine = 0u;
#pragma nounroll
        for (unsigned j = 0; j < 16; ++j) { const unsigned c = xb_ld(&bar[XB_XCNT(j)]); sum += c; cnt += (c > 0u) ? 1u : 0u; mine = (j == x) ? c : mine; }
        if (sum == G) break;
        __builtin_amdgcn_s_sleep(1);
        if ((++sp & 255u) == 0u) { if (xb_ld(&bar[XB_TMO])) break; if (sp > XB_SPIN_CAP) { atomicAdd(&bar[XB_TMO], 1u); break; } }
    }
    nloc = mine > 0u ? mine : 1u; nx = cnt > 0u ? cnt : 1u;
}
__device__ __forceinline__ void xcd_barrier(const XcdBarrier& b) {
    asm volatile("s_waitcnt vmcnt(0)" ::: "memory");
    __syncthreads();
    if (threadIdx.x == 0) {
        unsigned* bar = b.bar;
        __builtin_amdgcn_s_waitcnt(0);
        unsigned nloc = b.st[0], nx = b.st[1];
        if (nloc == 0u) { xcd_barrier_complete(bar, b.x, nloc, nx); b.st[0] = nloc; b.st[1] = nx; }
        const unsigned old = xb_add(&bar[XB_XSUB(b.x)], 1u);
        const unsigned gen = old / nloc;
        if (old + 1u == (gen + 1u) * nloc) {
            __builtin_amdgcn_fence(__ATOMIC_RELEASE, "agent");
            asm volatile("s_waitcnt vmcnt(0)" ::: "memory");
            const unsigned og = xb_add(&bar[XB_TOP], 1u);
            const unsigned tg = og / nx;
            if (og + 1u == (tg + 1u) * nx) xb_add(&bar[XB_TOPGEN], 1u);
            else XB_SPIN(xb_ld(&bar[XB_TOPGEN]) == tg, bar);
            __builtin_amdgcn_fence(__ATOMIC_ACQUIRE, "agent");
            xb_add(&bar[XB_XGEN(b.x)], 1u);
            asm volatile("s_waitcnt vmcnt(0)" ::: "memory");
        } else {
            XB_SPIN(xb_ld(&bar[XB_XGEN(b.x)]) == gen, bar);
            __builtin_amdgcn_fence(__ATOMIC_ACQUIRE, "agent");
            asm volatile("s_waitcnt vmcnt(0)" ::: "memory");
        }
    }
    __syncthreads();
}

namespace pg8 {
constexpr int BM = 256, BK = 64, HALF = 128, HTB = HALF * BK * 2, STAGE_BYTES = 8 * HTB;
__device__ __forceinline__ int lds_byte(int r, int c) { const int st = (r >> 4) * 2 + (c >> 5), rr = r & 15, cc = c & 31, ob = rr * 64 + cc * 2; return st * 1024 + (ob ^ (((ob >> 9) & 1) << 5)); }
__device__ __forceinline__ void stage_rc(int b, int& R, int& C) { const int st = b / 1024, sb = b % 1024, swz = sb ^ (((sb >> 9) & 1) << 5); R = (st >> 1) * 16 + swz / 64; C = (st & 1) * 32 + (swz % 64) / 2; }
__device__ __forceinline__ int perm32(int rho) { const int n = rho >> 4, i = rho & 15; return 8 * (i >> 2) + 4 * n + (i & 3); }

struct UnitX { unsigned a0, a1, b0, b1;
                unsigned r0, r1;
                int pm, pn, kind; };

template <class Epi, class Sched, bool ALIGN_EPI, bool GATHER>
__device__ __forceinline__ void gemm_phase(LAS unsigned char* lds, const int K, const char* Abase, const char* Bbase, const int* Lbase, const Sched& S, const Epi& E) {
    int tid_ = threadIdx.x; asm volatile("" : "+v"(tid_));
    const int tid = tid_, wid = __builtin_amdgcn_readfirstlane(tid >> 6), lane = tid & 63, wr = wid >> 2, wc = wid & 3, fr = lane & 15, fq = lane >> 4;
    const int nt = K / BK;
    unsigned voffB[2], vcon[2]; int Rr[2]; unsigned cby[2];
#pragma unroll
    for (int i = 0; i < 2; ++i) { int R, C; stage_rc(tid * 16 + i * 8192, R, C); const int Rb = Epi::PERM ? ((R & ~31) + perm32(R & 31)) : R;
        vcon[i] = (unsigned)(R * K + C) * 2u; voffB[i] = (unsigned)(Rb * K + C) * 2u; Rr[i] = R; cby[i] = (unsigned)C * 2u; }
    const unsigned kstep = (unsigned)(BK * 2);
    const unsigned ldsw = (unsigned)wid * 1024u;
    const int aoff = lds_byte(wr * 64 + fr, fq * 8), boff = lds_byte(wc * 32 + fr, fq * 8);
#define PG8_SA(b, h) (((b) * 2 + (h)) * HTB)
#define PG8_SB(b, h) ((4 + (b) * 2 + (h)) * HTB)
#define PG8_STAGE(bufoff, gbase, off32, voff) do { _Pragma("unroll") for (int _i = 0; _i < 2; ++_i) \
        __builtin_amdgcn_global_load_lds((const unsigned*)((gbase) + (size_t)((off32) + (voff)[_i])), (LAS unsigned*)(lds + (bufoff) + ldsw + _i * 8192), 16, 0, 0); } while (0)
#define PG8_LDA(dst, b, h) do { _Pragma("unroll") for (int m = 0; m < 4; ++m) _Pragma("unroll") for (int k = 0; k < 2; ++k) dst[m][k] = *(const LAS bf16x8*)(lds + PG8_SA(b, h) + aoff + m * 2048 + k * 1024); } while (0)
#define PG8_LDB(dst, b, h) do { _Pragma("unroll") for (int n = 0; n < 2; ++n) _Pragma("unroll") for (int k = 0; k < 2; ++k) dst[n][k] = *(const LAS bf16x8*)(lds + PG8_SB(b, h) + boff + n * 2048 + k * 1024); } while (0)
#define PG8_MMA(ai, bj, At, Bt) do { __builtin_amdgcn_s_setprio(1); _Pragma("unroll") for (int m = 0; m < 4; ++m) _Pragma("unroll") for (int n = 0; n < 2; ++n) _Pragma("unroll") for (int k = 0; k < 2; ++k) \
        acc[ai][bj][m][n] = __builtin_amdgcn_mfma_f32_16x16x32_bf16(Bt[n][k], At[m][k], acc[ai][bj][m][n], 0, 0, 0); __builtin_amdgcn_s_setprio(0); } while (0)
#define PG8_WAIT_V(n) asm volatile("s_waitcnt vmcnt(" #n ")" ::: "memory")
#define PG8_WAIT_L(n) asm volatile("s_waitcnt lgkmcnt(" #n ")" ::: "memory")
#define PG8_BAR __builtin_amdgcn_s_barrier()
#define PG8_SCHED __builtin_amdgcn_sched_barrier(0)
#define PG8_MKVA(u, v0, v1) do { _Pragma("unroll") for (int _i = 0; _i < 2; ++_i) { if constexpr (GATHER) { \
        unsigned i0 = (unsigned)Lbase[(u).r0 + Rr[_i]], i1 = (unsigned)Lbase[(u).r1 + Rr[_i]]; i0 = i0 < (unsigned)MR ? i0 : (unsigned)(MR - 1); i1 = i1 < (unsigned)MR ? i1 : (unsigned)(MR - 1); \
        v0[_i] = i0 * (unsigned)(K * 2) + cby[_i]; v1[_i] = i1 * (unsigned)(K * 2) + cby[_i]; } else { v0[_i] = vcon[_i]; v1[_i] = vcon[_i]; } } } while (0)
    UnitX cur, nxt; int ui = 0;
    if (!S.next(0, cur)) return;
    unsigned va0[2], va1[2], na0[2], na1[2];
    PG8_MKVA(cur, va0, va1);
    f32x4 acc[2][2][4][2];
#pragma unroll
    for (int a = 0; a < 2; ++a)
#pragma unroll
        for (int b = 0; b < 2; ++b)
#pragma unroll
            for (int m = 0; m < 4; ++m)
#pragma unroll
                for (int n = 0; n < 2; ++n) acc[a][b][m][n] = (f32x4){0.f, 0.f, 0.f, 0.f};
    bf16x8 At[4][2], B0[2][2], B1[2][2];
    PG8_STAGE(PG8_SB(0, 0), Bbase, cur.b0, voffB); PG8_STAGE(PG8_SB(0, 1), Bbase, cur.b1, voffB); PG8_STAGE(PG8_SA(0, 0), Abase, cur.a0, va0); PG8_STAGE(PG8_SA(0, 1), Abase, cur.a1, va1);
    if (wr == 1) PG8_BAR;
    PG8_WAIT_V(2); PG8_BAR;
    PG8_STAGE(PG8_SB(1, 0), Bbase, cur.b0 + kstep, voffB); PG8_STAGE(PG8_SA(1, 0), Abase, cur.a0 + kstep, va0); PG8_STAGE(PG8_SB(1, 1), Bbase, cur.b1 + kstep, voffB);
    PG8_WAIT_V(6); PG8_BAR;
    for (;;) {
        const bool has_next = S.next(ui + 1, nxt);
        if (has_next) { PG8_MKVA(nxt, na0, na1); } else { nxt = cur;
#pragma unroll
            for (int i = 0; i < 2; ++i) { na0[i] = va0[i]; na1[i] = va1[i]; } }
#pragma nounroll
        for (int t = 0; t < nt; t += 2) {
            const bool last = (t == nt - 2);
            const unsigned a1h1 = cur.a1 + (unsigned)(t + 1) * kstep;
            const unsigned p2a0 = last ? nxt.a0 : cur.a0 + (unsigned)(t + 2) * kstep, p2a1 = last ? nxt.a1 : cur.a1 + (unsigned)(t + 2) * kstep;
            const unsigned p2b0 = last ? nxt.b0 : cur.b0 + (unsigned)(t + 2) * kstep, p2b1 = last ? nxt.b1 : cur.b1 + (unsigned)(t + 2) * kstep;
            unsigned w0[2], w1[2];
#pragma unroll
            for (int i = 0; i < 2; ++i) { w0[i] = last ? na0[i] : va0[i]; w1[i] = last ? na1[i] : va1[i]; }
            PG8_LDB(B0, 0, 0); PG8_LDB(B1, 0, 1); PG8_SCHED; PG8_LDA(At, 0, 0); PG8_STAGE(PG8_SA(1, 1), Abase, a1h1, va1);
            PG8_WAIT_V(8); PG8_WAIT_L(0); PG8_BAR; PG8_MMA(0, 0, At, B0); PG8_MMA(0, 1, At, B1); PG8_BAR; PG8_SCHED;
            PG8_LDA(At, 0, 1); PG8_STAGE(PG8_SB(0, 0), Bbase, p2b0, voffB); PG8_STAGE(PG8_SB(0, 1), Bbase, p2b1, voffB); PG8_STAGE(PG8_SA(0, 0), Abase, p2a0, w0);
            PG8_WAIT_V(8); PG8_WAIT_L(0); PG8_BAR; PG8_MMA(1, 0, At, B0); PG8_MMA(1, 1, At, B1); PG8_BAR; PG8_SCHED;
            PG8_LDB(B0, 1, 0); PG8_LDB(B1, 1, 1); PG8_SCHED; PG8_LDA(At, 1, 0); PG8_STAGE(PG8_SA(0, 1), Abase, p2a1, w1);
            PG8_WAIT_V(8); PG8_WAIT_L(0); PG8_BAR; PG8_MMA(0, 0, At, B0); PG8_MMA(0, 1, At, B1); PG8_BAR; PG8_SCHED;
            PG8_LDA(At, 1, 1); PG8_STAGE(PG8_SB(1, 0), Bbase, p2b0 + kstep, voffB); PG8_STAGE(PG8_SB(1, 1), Bbase, p2b1 + kstep, voffB); PG8_STAGE(PG8_SA(1, 0), Abase, p2a0 + kstep, w0);
            PG8_WAIT_V(8); PG8_WAIT_L(0); PG8_BAR; PG8_MMA(1, 0, At, B0); PG8_MMA(1, 1, At, B1); PG8_BAR; PG8_SCHED;
        }
        if constexpr (ALIGN_EPI) { if (wr == 0) PG8_BAR; }
        E(acc, cur, wr, wc, fr, fq);
        if (!has_next) break;
#pragma unroll
        for (int a = 0; a < 2; ++a)
#pragma unroll
            for (int b = 0; b < 2; ++b)
#pragma unroll
                for (int m = 0; m < 4; ++m)
#pragma unroll
                    for (int n = 0; n < 2; ++n) acc[a][b][m][n] = (f32x4){0.f, 0.f, 0.f, 0.f};
        cur = nxt; ++ui;
#pragma unroll
        for (int i = 0; i < 2; ++i) { va0[i] = na0[i]; va1[i] = na1[i]; }
        if constexpr (ALIGN_EPI) { if (wr == 1) PG8_BAR; }
    }
    PG8_WAIT_V(0);
    if constexpr (!ALIGN_EPI) { if (wr == 0) PG8_BAR; }
    PG8_BAR;
#undef PG8_SA
#undef PG8_SB
#undef PG8_STAGE
#undef PG8_LDA
#undef PG8_LDB
#undef PG8_MMA
#undef PG8_WAIT_V
#undef PG8_WAIT_L
#undef PG8_BAR
#undef PG8_SCHED
#undef PG8_MKVA
}

__device__ __forceinline__ bool static_order(int i, int G, int c, int nM, int nN, int& pm, int& pn) {
    constexpr int NXCD = 8, WGM = 8;
    const int nwg = nM * nN; const long L = (long)i * G + c; if (L >= nwg) return false;
    int wgid = (int)L; { const int q = nwg / NXCD, r = nwg % NXCD, xcd = wgid % NXCD, off = wgid / NXCD; wgid = (xcd < r ? xcd * (q + 1) : r * (q + 1) + (xcd - r) * q) + off; }
    const int nig = WGM * nN, gid = wgid / nig, fm = gid * WGM, gsz = (nM - fm) < WGM ? (nM - fm) : WGM;
    pm = fm + ((wgid % nig) % gsz); pn = (wgid % nig) / gsz; return true;
}
template <int MODE> struct DenseSched {
    int K, nN, G, c;
    __device__ __forceinline__ bool next(int i, UnitX& u) const {
        int pm, pn; if (!static_order(i, G, c, MX / 256, nN, pm, pn)) return false;
        const unsigned K2 = (unsigned)K * 2u;
        u.a0 = (unsigned)pm * 256u * K2; u.a1 = u.a0 + 128u * K2; u.r0 = 0u; u.r1 = 0u; u.pm = pm; u.pn = pn;
        if (MODE == 1 && pn >= 4) { const unsigned q = (unsigned)(pn - 4); u.b0 = (1024u + 128u * q) * K2; u.b1 = (2048u + 128u * q) * K2; u.kind = 1; }
        else { u.b0 = (unsigned)pn * 256u * K2; u.b1 = u.b0 + 128u * K2; u.kind = 0; }
        return true;
    }
};
struct MoeSched1 {
    const volatile LAS int* tt; int G, c;
    __device__ __forceinline__ bool next(int i, UnitX& u) const {
        const int L = i * G + c; const int nT = __builtin_amdgcn_readfirstlane(tt[32]); if (L >= 2 * nT) return false;
        const int t = L >> 1, fh = L & 1; int e = 0;
#pragma nounroll
        for (int j = 1; j < 32; ++j) e += (__builtin_amdgcn_readfirstlane(tt[j]) <= t) ? 1 : 0;
        const int jt = t - __builtin_amdgcn_readfirstlane(tt[e]);
        u.a0 = 0u; u.a1 = 0u; u.r0 = (unsigned)e * (unsigned)LCAP + 256u * (unsigned)jt; u.r1 = u.r0 + 128u;
        const unsigned we = (unsigned)e * (unsigned)WMOE_EXPERT; u.b0 = we + (unsigned)fh * 128u * 2048u; u.b1 = we + (unsigned)WMOE_PART + (unsigned)fh * 128u * 2048u;
        u.pm = t; u.pn = fh; u.kind = 0; return true;
    }
};
struct MoeSched2 {
    const volatile LAS int* tt; int G, c;
    __device__ __forceinline__ bool next(int i, UnitX& u) const {
        const int L = i * G + c; const int nT = __builtin_amdgcn_readfirstlane(tt[32]); if (L >= 4 * nT) return false;
        const int t = L >> 2, pn = L & 3; int e = 0;
#pragma nounroll
        for (int j = 1; j < 32; ++j) e += (__builtin_amdgcn_readfirstlane(tt[j]) <= t) ? 1 : 0;
        u.a0 = (unsigned)t * 256u * 512u; u.a1 = u.a0 + 128u * 512u; u.r0 = 0u; u.r1 = 0u;
        const unsigned we = (unsigned)e * (unsigned)WMOE_EXPERT + 2u * (unsigned)WMOE_PART; u.b0 = we + (unsigned)pn * 256u * 512u; u.b1 = u.b0 + 128u * 512u;
        u.pm = t; u.pn = pn; u.kind = 0; return true;
    }
};

struct EpiIn {
    static constexpr bool PERM = true;
    bf16* GB; bf16* U;
    __device__ __forceinline__ void operator()(const f32x4 (&acc)[2][2][4][2], const UnitX& u, int wr, int wc, int fr, int fq) const {
        const int row0 = u.pm * 256 + wr * 64 + fr, cw = wc * 32 + 8 * fq;
        if (u.kind == 0) {
#pragma unroll
            for (int ai = 0; ai < 2; ++ai)
#pragma unroll
                for (int m = 0; m < 4; ++m) { bf16* rowp = GB + (size_t)(row0 + ai * 128 + m * 16) * D + u.pn * 256 + cw;
#pragma unroll
                    for (int bj = 0; bj < 2; ++bj) store8bf(rowp + bj * 128, acc[ai][bj][m][0], acc[ai][bj][m][1]); }
        } else {
            const int q = u.pn - 4;
#pragma unroll
            for (int ai = 0; ai < 2; ++ai)
#pragma unroll
                for (int m = 0; m < 4; ++m) { bf16* rowp = U + (size_t)(row0 + ai * 128 + m * 16) * D + q * 128 + cw;
                    store8bf(rowp, acc[ai][0][m][0] * acc[ai][1][m][0], acc[ai][0][m][1] * acc[ai][1][m][1]); }
        }
    }
};
struct EpiRes {
    static constexpr bool PERM = false;
    const float* base; float* out;
    __device__ __forceinline__ void operator()(const f32x4 (&acc)[2][2][4][2], const UnitX& u, int wr, int wc, int fr, int fq) const {
        const int row0 = u.pm * 256 + wr * 64 + fr, col0 = u.pn * 256 + wc * 32 + 4 * fq;
        f32x4 cv[4], nv[4];
#define EPR_OFF(g) ((size_t)(row0 + ((g) >> 2) * 128 + ((g) & 3) * 16) * D + col0)
#define EPR_LOAD(dst, g) do { const float* p_ = base + EPR_OFF(g); dst[0] = *(const f32x4*)(p_); dst[1] = *(const f32x4*)(p_ + 16); dst[2] = *(const f32x4*)(p_ + 128); dst[3] = *(const f32x4*)(p_ + 144); } while (0)
        EPR_LOAD(cv, 0);
#pragma unroll
        for (int g = 0; g < 8; ++g) {
            if (g < 7) EPR_LOAD(nv, g + 1);
            float* o_ = out + EPR_OFF(g); const int ai = g >> 2, m = g & 3;
            *(f32x4*)(o_) = cv[0] + acc[ai][0][m][0]; *(f32x4*)(o_ + 16) = cv[1] + acc[ai][0][m][1]; *(f32x4*)(o_ + 128) = cv[2] + acc[ai][1][m][0]; *(f32x4*)(o_ + 144) = cv[3] + acc[ai][1][m][1];
#pragma unroll
            for (int q = 0; q < 4; ++q) cv[q] = nv[q];
        }
#undef EPR_OFF
#undef EPR_LOAD
    }
};
struct EpiQKV {
    static constexpr bool PERM = true;
    bf16* Q; bf16* Kb; bf16* Vb; const float* rope;
    __device__ __forceinline__ void operator()(const f32x4 (&acc)[2][2][4][2], const UnitX& u, int wr, int wc, int fr, int fq) const {
        const int row0 = u.pm * 256 + wr * 64 + fr;
        if (u.pn == 5) {
#pragma unroll
            for (int g = 0; g < 8; ++g) { const int ai = g >> 2, m = g & 3, row = row0 + ai * 128 + m * 16, b = row >> 13, s = row & (SEQ - 1);
                bf16* rowp = Vb + ((size_t)b * KVROWS + 128 + s) * 256 + wc * 32 + 8 * fq;
                store8bf(rowp, acc[ai][0][m][0], acc[ai][0][m][1]); store8bf(rowp + 128, acc[ai][1][m][0], acc[ai][1][m][1]); }
            return;
        }
        f32x4 cv[4], nv[4];
#define EPQ_LOAD(dst, g) do { const int row_ = row0 + ((g) >> 2) * 128 + ((g) & 3) * 16; const float* rp_ = rope + (size_t)(NMETA + (row_ & (SEQ - 1))) * 64 + 8 * fq; \
        dst[0] = *(const f32x4*)(rp_); dst[1] = *(const f32x4*)(rp_ + 4); dst[2] = *(const f32x4*)(rp_ + 32); dst[3] = *(const f32x4*)(rp_ + 36); } while (0)
        EPQ_LOAD(cv, 0);
#pragma unroll
        for (int g = 0; g < 8; ++g) {
            if (g < 7) EPQ_LOAD(nv, g + 1);
            const int ai = g >> 2, m = g & 3, row = row0 + ai * 128 + m * 16, b = row >> 13, s = row & (SEQ - 1);
            const f32x4 x10 = acc[ai][0][m][0], x11 = acc[ai][0][m][1], x20 = acc[ai][1][m][0], x21 = acc[ai][1][m][1];
            f32x4 o10 = x10 * cv[0] - x20 * cv[2], o11 = x11 * cv[1] - x21 * cv[3], o20 = x20 * cv[0] + x10 * cv[2], o21 = x21 * cv[1] + x11 * cv[3];
            bf16* dst;
            if (u.pn < 4) { o10 *= QSCALE; o11 *= QSCALE; o20 *= QSCALE; o21 *= QSCALE; dst = Q + (size_t)row * D + (u.pn * 4 + wc) * 64 + 8 * fq; }
            else dst = Kb + ((size_t)b * KVROWS + 128 + s) * 256 + wc * 64 + 8 * fq;
            store8bf(dst, o10, o11); store8bf(dst + 32, o20, o21);
#pragma unroll
            for (int q = 0; q < 4; ++q) cv[q] = nv[q];
        }
#undef EPQ_LOAD
    }
};
struct EpiHdn {
    static constexpr bool PERM = true;
    bf16* HDN;
    __device__ __forceinline__ void operator()(const f32x4 (&acc)[2][2][4][2], const UnitX& u, int wr, int wc, int fr, int fq) const {
        const int row0 = u.pm * 256 + wr * 64 + fr;
#pragma unroll
        for (int ai = 0; ai < 2; ++ai)
#pragma unroll
            for (int m = 0; m < 4; ++m) { bf16* rowp = HDN + (size_t)(row0 + ai * 128 + m * 16) * FE + u.pn * 128 + wc * 32 + 8 * fq;
                f32x4 h[2];
#pragma unroll
                for (int n = 0; n < 2; ++n)
#pragma unroll
                    for (int e = 0; e < 4; ++e) { const float g = acc[ai][0][m][n][e], up = acc[ai][1][m][n][e]; h[n][e] = g * __builtin_amdgcn_rcpf(1.f + __builtin_amdgcn_exp2f(-g * LOG2E)) * up; }
                store8bf(rowp, h[0], h[1]); }
    }
};
struct EpiY {
    static constexpr bool PERM = true;
    bf16* Y;
    __device__ __forceinline__ void operator()(const f32x4 (&acc)[2][2][4][2], const UnitX& u, int wr, int wc, int fr, int fq) const {
        const int row0 = u.pm * 256 + wr * 64 + fr;
#pragma unroll
        for (int ai = 0; ai < 2; ++ai)
#pragma unroll
            for (int m = 0; m < 4; ++m) { bf16* rowp = Y + (size_t)(row0 + ai * 128 + m * 16) * D + u.pn * 256 + wc * 32 + 8 * fq;
#pragma unroll
                for (int bj = 0; bj < 2; ++bj) store8bf(rowp + bj * 128, acc[ai][bj][m][0], acc[ai][bj][m][1]); }
    }
};
}

struct Args {
    const float* in[21]; float* out; unsigned char* ws; float inv_freq[32]; int pad0, pad1;
};
struct Frame {
    LAS unsigned char* lds; gu32* ctl; unsigned char* ws;
    int tid, lane, wave, vcu, G;
    float* out; float* HM;
};
__device__ __forceinline__ float* hrow(const Frame& F, int r) { return r < MX ? F.out + (size_t)r * D : F.HM + (size_t)(r - MX) * D; }

__device__ __forceinline__ void transpose_tile(const float* W, int ldw, int nsrc0, int k0, const float* g, bf16* Wt, int Kd, int dbase, int nrel0, int kind, LAS unsigned* scr, int lane) {
    const int nl = 4 * (lane & 15), kq = lane >> 4;
    f32x4 v0[8], v1[8]; f32x2 gg[8];
#pragma unroll
    for (int i = 0; i < 8; ++i) { const int k = k0 + 2 * (4 * i + kq); v0[i] = *(const f32x4*)(W + (size_t)k * ldw + nsrc0 + nl); v1[i] = *(const f32x4*)(W + (size_t)(k + 1) * ldw + nsrc0 + nl); }
    const float* gp = g ? g : W;
#pragma unroll
    for (int i = 0; i < 8; ++i) { const f32x2 t = *(const f32x2*)(gp + k0 + 2 * (4 * i + kq)); gg[i] = g ? t : (f32x2){1.f, 1.f}; }
#pragma unroll
    for (int i = 0; i < 8; ++i) { const int kp = 4 * i + kq;
#pragma unroll
        for (int e = 0; e < 4; ++e) scr[(nl + e) * 33 + kp] = pk2(v0[i][e] * gg[i].x, v1[i][e] * gg[i].y); }
    LDS_WAIT(); asm volatile("" ::: "memory");
    const int ch = lane & 7;
#pragma unroll
    for (int j = 0; j < 8; ++j) {
        const int r = (lane >> 3) + 8 * j; const LAS unsigned* s = scr + r * 33 + 4 * ch;
        u32x4 o; o.x = s[0]; o.y = s[1]; o.z = s[2]; o.w = s[3];
        const int n = nrel0 + r; int dr;
        if (kind == 0) dr = dbase + n; else { const int head = n >> 6, d = n & 63; dr = dbase + (head >> 2) * 256 + (d >> 5) * 128 + (head & 3) * 32 + (d & 31); }
        *(u32x4*)(Wt + (size_t)dr * Kd + k0 + 8 * ch) = o;
    }
    LDS_WAIT(); asm volatile("" ::: "memory");
}
__device__ __forceinline__ void transpose_matrix_item(int item, const float* W, int ldw, int nsrc_base, int K, int ncols, const float* g, bf16* Wt, int dbase, int kind, LAS unsigned* scr, int lane) {
    const int nb = ncols / 64, kb = item / nb, cb = item % nb;
    transpose_tile(W, ldw, nsrc_base + 64 * cb, 64 * kb, g, Wt, K, dbase, 64 * cb, kind, scr, lane);
}
__device__ __forceinline__ void rms_row_to_bf16(const float* xrow, bf16* orow, int lane) {
    const f32x4* xr = (const f32x4*)xrow + lane; f32x4 v[4]; float s = 0.f;
#pragma unroll
    for (int j = 0; j < 4; ++j) { v[j] = xr[64 * j]; s += (v[j].x * v[j].x + v[j].y * v[j].y) + (v[j].z * v[j].z + v[j].w * v[j].w); }
    const float rstd = 1.0f / sqrtf(wave_sum(s) * (1.f / D) + EPS);
    u32x2* o8 = (u32x2*)orow + lane;
#pragma unroll
    for (int j = 0; j < 4; ++j) { u32x2 w; w.x = pk2(v[j].x * rstd, v[j].y * rstd); w.y = pk2(v[j].z * rstd, v[j].w * rstd); o8[64 * j] = w; }
}

template <int NT> __device__ __forceinline__ void meta_mm(const bf16* A, const bf16* const (&B)[NT], int K, f32x4 (&acc)[NT], int lane) {
    const int fr = lane & 15, fq = lane >> 4;
    const bf16* ap = A + (size_t)fr * K + 8 * fq;
#pragma unroll
    for (int t = 0; t < NT; ++t) acc[t] = (f32x4){0.f, 0.f, 0.f, 0.f};
#pragma unroll 4
    for (int s = 0; s < K / 32; ++s) {
        const bf16x8 af = *(const bf16x8*)(ap + 32 * s);
#pragma unroll
        for (int t = 0; t < NT; ++t) { const bf16x8 bfr = *(const bf16x8*)(B[t] + (size_t)fr * K + 8 * fq + 32 * s); acc[t] = __builtin_amdgcn_mfma_f32_16x16x32_bf16(bfr, af, acc[t], 0, 0, 0); }
    }
}

__device__ __forceinline__ void router_phase(Frame& F, int nrows, const bf16* WR  , const float* gb, const float* eb, unsigned* cnt  , int* list, unsigned* pos, float* topw, bf16* XN) {
    const int lane = F.lane, fr = lane & 15, fq = lane >> 4;
    LAS float* scr = (LAS float*)(F.lds + F.wave * 4096);
    const int ngroups = nrows / 16;
    for (int grp = F.vcu + F.G * F.wave; grp < ngroups; grp += F.G * 8) {
        const int rb = grp * 16;
        const float* hp = hrow(F, rb + fr) + 8 * fq;
        f32x4 acc[3]; acc[0] = acc[1] = acc[2] = (f32x4){0.f, 0.f, 0.f, 0.f}; float ss = 0.f;
#pragma unroll 2
        for (int s = 0; s < 32; ++s) {
            const f32x4 h0 = *(const f32x4*)(hp + 32 * s), h1 = *(const f32x4*)(hp + 32 * s + 4);
            ss += (h0.x * h0.x + h0.y * h0.y) + (h0.z * h0.z + h0.w * h0.w) + (h1.x * h1.x + h1.y * h1.y) + (h1.z * h1.z + h1.w * h1.w);
            u32x4 hi, lo; float r[8] = {h0.x, h0.y, h0.z, h0.w, h1.x, h1.y, h1.z, h1.w}; float l[8];
#pragma unroll
            for (int e = 0; e < 8; ++e) { const float hh = bf2f(f2bf(r[e])); l[e] = r[e] - hh; }
            hi.x = pk2(r[0], r[1]); hi.y = pk2(r[2], r[3]); hi.z = pk2(r[4], r[5]); hi.w = pk2(r[6], r[7]);
            lo.x = pk2(l[0], l[1]); lo.y = pk2(l[2], l[3]); lo.z = pk2(l[4], l[5]); lo.w = pk2(l[6], l[7]);
            const bf16x8 ah = __builtin_bit_cast(bf16x8, hi), al = __builtin_bit_cast(bf16x8, lo);
#pragma unroll
            for (int t = 0; t < 3; ++t) {
                const bf16x8 bh = *(const bf16x8*)(WR + (size_t)(16 * t + fr) * D + 8 * fq + 32 * s), bl = *(const bf16x8*)(WR + (size_t)(48 + 16 * t + fr) * D + 8 * fq + 32 * s);
                acc[t] = __builtin_amdgcn_mfma_f32_16x16x32_bf16(bh, ah, acc[t], 0, 0, 0);
                acc[t] = __builtin_amdgcn_mfma_f32_16x16x32_bf16(bh, al, acc[t], 0, 0, 0);
                acc[t] = __builtin_amdgcn_mfma_f32_16x16x32_bf16(bl, ah, acc[t], 0, 0, 0);
            }
        }
        ss += __shfl_xor(ss, 16); ss += __shfl_xor(ss, 32);
        const float rstd = 1.0f / sqrtf(ss * (1.f / D) + EPS);
#pragma unroll
        for (int t = 0; t < 3; ++t)
#pragma unroll
            for (int e = 0; e < 4; ++e) scr[fr * 48 + 16 * t + 4 * fq + e] = acc[t][e] * rstd;
        if (fq == 0) scr[768 + fr] = rstd;
        LDS_WAIT(); asm volatile("" ::: "memory");
        if (lane < 16) {
            const LAS float* lg = scr + lane * 48; const int row = rb + lane;
            float gl[4]; int gi = 0; float gm = -INFINITY;
#pragma unroll
            for (int j = 0; j < 4; ++j) { gl[j] = lg[j] + gb[j]; if (gl[j] > gm) { gm = gl[j]; gi = j; } }
            float gs = 0.f;
#pragma unroll
            for (int j = 0; j < 4; ++j) gs += __expf(gl[j] - gm);
            const float gw = 1.0f / gs;
            float v1 = -INFINITY, v2 = -INFINITY; int i1 = 0, i2 = 0;
#pragma unroll
            for (int j = 0; j < 8; ++j) { const float v = lg[4 + gi * 8 + j] + eb[gi * 8 + j];
                if (v > v1) { v2 = v1; i2 = i1; v1 = v; i1 = j; } else if (v > v2) { v2 = v; i2 = j; } }
            const float e2 = __expf(v2 - v1), w1 = gw / (1.f + e2), w2 = gw * e2 / (1.f + e2);
            const int ex1 = gi * 8 + i1, ex2 = gi * 8 + i2;
            const unsigned j1 = atomicAdd(cnt + ex1 * 64, 1u), j2 = atomicAdd(cnt + ex2 * 64, 1u);
            list[(size_t)ex1 * LCAP + j1] = row; list[(size_t)ex2 * LCAP + j2] = row;
            pos[2 * row] = ((unsigned)ex1 << 16) | j1; pos[2 * row + 1] = ((unsigned)ex2 << 16) | j2;
            topw[2 * row] = w1; topw[2 * row + 1] = w2;
        }
        for (int i = 0; i < 16; ++i) {
            const float rs = scr[768 + i]; const f32x4* xr = (const f32x4*)hrow(F, rb + i) + lane; u32x2* o8 = (u32x2*)(XN + (size_t)(rb + i) * D) + lane;
#pragma unroll
            for (int j = 0; j < 4; ++j) { const f32x4 v = xr[64 * j]; u32x2 w; w.x = pk2(v.x * rs, v.y * rs); w.y = pk2(v.z * rs, v.w * rs); o8[64 * j] = w; }
        }
        LDS_WAIT(); asm volatile("" ::: "memory");
    }
}

__device__ __forceinline__ void build_tile_table(Frame& F, const unsigned* cnt) {
    volatile LAS int* tt = (volatile LAS int*)(F.lds + TILETAB_OFF);
    if (F.tid == 0) { int acc = 0;
#pragma nounroll
        for (int e = 0; e < 32; ++e) { tt[e] = acc; const unsigned n = __hip_atomic_load(cnt + e * 64, RLX_AGENT); acc += (int)((n + 255u) >> 8); } tt[32] = acc < MAXTILES ? acc : MAXTILES; }
    __syncthreads();
}

template <bool FINAL> __device__ __forceinline__ void combine_phase(Frame& F, int nrows, const bf16* Y, const unsigned* pos, const float* topw, bf16* XN, const float* gfin) {
    const volatile LAS int* tt = (const volatile LAS int*)(F.lds + TILETAB_OFF);
    const int lane = F.lane;
    for (int row = F.vcu * 8 + F.wave; row < nrows; row += F.G * 8) {
        const unsigned p0 = pos[2 * row], p1 = pos[2 * row + 1]; const float w0 = topw[2 * row], w1 = topw[2 * row + 1];
        const size_t y0 = ((size_t)tt[p0 >> 16] * 256 + (p0 & 0xffffu)) * D, y1 = ((size_t)tt[p1 >> 16] * 256 + (p1 & 0xffffu)) * D;
        float* hp = hrow(F, row); f32x4 v[4]; float s = 0.f;
#pragma unroll
        for (int j = 0; j < 4; ++j) {
            v[j] = ((const f32x4*)hp)[lane + 64 * j];
            const u32x2 a = ((const u32x2*)(Y + y0))[lane + 64 * j], b = ((const u32x2*)(Y + y1))[lane + 64 * j];
            v[j].x += w0 * bf2f(a.x & 0xffffu) + w1 * bf2f(b.x & 0xffffu); v[j].y += w0 * bf2f(a.x >> 16) + w1 * bf2f(b.x >> 16);
            v[j].z += w0 * bf2f(a.y & 0xffffu) + w1 * bf2f(b.y & 0xffffu); v[j].w += w0 * bf2f(a.y >> 16) + w1 * bf2f(b.y >> 16);
            s += (v[j].x * v[j].x + v[j].y * v[j].y) + (v[j].z * v[j].z + v[j].w * v[j].w);
        }
        const float rstd = 1.0f / sqrtf(wave_sum(s) * (1.f / D) + EPS);
        if (FINAL) {
#pragma unroll
            for (int j = 0; j < 4; ++j) { const f32x4 g = ((const f32x4*)gfin)[lane + 64 * j]; ((f32x4*)hp)[lane + 64 * j] = v[j] * rstd * g; }
        } else {
            u32x2* o8 = (u32x2*)(XN + (size_t)row * D) + lane;
#pragma unroll
            for (int j = 0; j < 4; ++j) { ((f32x4*)hp)[lane + 64 * j] = v[j]; u32x2 w; w.x = pk2(v[j].x * rstd, v[j].y * rstd); w.y = pk2(v[j].z * rstd, v[j].w * rstd); o8[64 * j] = w; }
        }
    }
}

__device__ __forceinline__ int crow(int r, int hi) { return (r & 3) + 8 * (r >> 2) + 4 * hi; }
typedef short v4i16_t __attribute__((ext_vector_type(4)));
__device__ __forceinline__ s16x4 vtr(const LAS unsigned char* p) { return __builtin_bit_cast(s16x4, __builtin_amdgcn_ds_read_tr16_b64_v4i16((LAS v4i16_t*)p)); }
constexpr int AT_K = 0, AT_V = 24576, AT_WS = 49152, AT_OST = 51200;
__device__ __forceinline__ void attn_phase(Frame& F, const bf16* Q, const bf16* Kb, const bf16* Vb, bf16* O, const float* sinks) {
    const int lane = F.lane, r32 = lane & 31, hi = lane >> 5, wid = F.wave;
    LAS unsigned char* lds = F.lds;
    LAS float* wsf = (LAS float*)(lds + AT_WS) + wid * 64;
    const int g = wid >> 1, sb = wid & 1;
    for (int u = F.vcu; u < 1024; u += F.G) {
        const int bkv = u >> 7, qb = u & 127, b = bkv >> 2, kvh = bkv & 3, head = kvh * 4 + g;
        const size_t R0 = (size_t)b * KVROWS + 64 * qb;
#pragma unroll
        for (int sl = 0; sl < 3; ++sl) {
            const bf16* ks = Kb + (R0 + 64 * sl + lane) * 256 + kvh * 64 + wid * 8;
            const bf16* vs = Vb + (R0 + 64 * sl + 16 * (wid & 3) + (lane >> 2)) * 256 + kvh * 64 + (wid >> 2) * 32 + (lane & 3) * 8;
            __builtin_amdgcn_global_load_lds((const unsigned*)ks, (LAS unsigned*)(lds + AT_K + sl * 8192 + wid * 1024), 16, 0, 0);
            __builtin_amdgcn_global_load_lds((const unsigned*)vs, (LAS unsigned*)(lds + AT_V + sl * 8192 + wid * 1024), 16, 0, 0);
        }
        const size_t qrow0 = (size_t)b * SEQ + 64 * qb + 32 * sb;
        bf16x8 qr[4];
#pragma unroll
        for (int d0 = 0; d0 < 4; ++d0) qr[d0] = *(const bf16x8*)(Q + (qrow0 + r32) * D + head * 64 + d0 * 16 + hi * 8);
        const float sink2 = sinks[head] * LOG2E;
        VM_WAIT(); __syncthreads();
        f32x16 p[5];
#pragma unroll
        for (int jj = 0; jj < 5; ++jj) {
            const int j = sb + jj; const LAS unsigned char* kb = lds + AT_K + (j >> 1) * 8192 + (j & 1) * 512 + hi * 1024 + r32 * 16;
            p[jj] = (f32x16){0.f, 0.f, 0.f, 0.f, 0.f, 0.f, 0.f, 0.f, 0.f, 0.f, 0.f, 0.f, 0.f, 0.f, 0.f, 0.f};
#pragma unroll
            for (int d0 = 0; d0 < 4; ++d0) { const bf16x8 kf = *(const LAS bf16x8*)(kb + d0 * 2048); p[jj] = __builtin_amdgcn_mfma_f32_32x32x16_bf16(kf, qr[d0], p[jj], 0, 0, 0); }
        }
        const int qrel = 128 + 32 * sb + r32; float m = sink2;
#pragma unroll
        for (int jj = 0; jj < 5; ++jj)
#pragma unroll
            for (int r = 0; r < 16; ++r) { const int kr = 32 * (sb + jj) + crow(r, hi), diff = qrel - kr; const bool ok = (diff >= 0) && (diff < 128) && (64 * qb + kr >= 112);
                const float v = ok ? p[jj][r] : -1e30f; p[jj][r] = v; m = fmaxf(m, v); }
        m = fmaxf(m, __shfl_xor(m, 32));
        float l = 0.f;
#pragma unroll
        for (int jj = 0; jj < 5; ++jj)
#pragma unroll
            for (int r = 0; r < 16; ++r) { const float e = __builtin_amdgcn_exp2f(p[jj][r] - m); p[jj][r] = e; l += e; }
        l += __shfl_xor(l, 32); l += __builtin_amdgcn_exp2f(sink2 - m);
        f32x16 o[2]; o[0] = (f32x16){0.f, 0.f, 0.f, 0.f, 0.f, 0.f, 0.f, 0.f, 0.f, 0.f, 0.f, 0.f, 0.f, 0.f, 0.f, 0.f}; o[1] = o[0];
        const int vlane = ((lane >> 4) & 1) * 32 + (lane & 3) * 8 + (4 * hi + ((lane & 15) >> 2)) * 64;
#pragma unroll
        for (int jj = 0; jj < 5; ++jj) {
            const int j = sb + jj; const LAS unsigned char* vb = lds + AT_V + (j >> 1) * 8192 + (j & 1) * 2048 + vlane;
#pragma unroll
            for (int s = 0; s < 2; ++s) {
                u32x4 pw; pw.x = pk2(p[jj][8 * s + 0], p[jj][8 * s + 1]); pw.y = pk2(p[jj][8 * s + 2], p[jj][8 * s + 3]); pw.z = pk2(p[jj][8 * s + 4], p[jj][8 * s + 5]); pw.w = pk2(p[jj][8 * s + 6], p[jj][8 * s + 7]);
                const bf16x8 pa = __builtin_bit_cast(bf16x8, pw);
#pragma unroll
                for (int d0 = 0; d0 < 2; ++d0) {
                    const s16x4 lo = vtr(vb + d0 * 4096 + s * 1024), hh = vtr(vb + d0 * 4096 + s * 1024 + 512);
                    const bf16x8 vf = (bf16x8){lo[0], lo[1], lo[2], lo[3], hh[0], hh[1], hh[2], hh[3]};
                    o[d0] = __builtin_amdgcn_mfma_f32_32x32x16_bf16(pa, vf, o[d0], 0, 0, 0);
                }
            }
        }
        if (hi == 0) wsf[r32] = l;
        LDS_WAIT(); asm volatile("" ::: "memory");
        bf16* Ow = O + qrow0 * D + head * 64;
        LAS bf16* stg = (LAS bf16*)(lds + AT_OST) + wid * 2048;
#pragma unroll
        for (int r = 0; r < 16; ++r) { const int orow = crow(r, hi); const float rl = __builtin_amdgcn_rcpf(wsf[orow]);
#pragma unroll
            for (int d0 = 0; d0 < 2; ++d0) stg[orow * 64 + d0 * 32 + r32] = (bf16)f2bf(o[d0][r] * rl); }
        LDS_WAIT(); asm volatile("" ::: "memory");
#pragma unroll
        for (int i = 0; i < 4; ++i) { const int row = i * 8 + (lane >> 3), ch = lane & 7; const u32x4 v = *(const LAS u32x4*)(stg + row * 64 + ch * 8); *(u32x4*)(Ow + (size_t)row * D + ch * 8) = v; }
        LDS_WAIT(); __syncthreads();
    }
}

#ifndef PHMASK
#define PHMASK 0xFFFF
#endif
#define PHON(k) ((PHMASK >> (k)) & 1)
__global__ void __launch_bounds__(512, 2) yoco_fwd(Args args) {
    extern __shared__ __attribute__((aligned(16))) unsigned char lds_raw[];
    const int bx_ = blockIdx.x, G_ = gridDim.x, vcu_ = (G_ % 8 == 0) ? (bx_ % 8) * (G_ / 8) + bx_ / 8 : bx_;
    unsigned char* ws = args.ws; gu32* ctl = (gu32*)(ws + WS_CTL);
    for (int u = threadIdx.x; u < (LDS_BYTES - RING_BYTES) / 4; u += 512) ((LAS unsigned*)((LAS unsigned char*)lds_raw + RING_BYTES))[u] = 0u;
    __syncthreads();
    volatile LAS unsigned* MISC = (volatile LAS unsigned*)((LAS unsigned char*)lds_raw + MISC_OFF);
    XcdBarrier bar = xcd_barrier_post((unsigned*)(ctl + CW_BAR), MISC + 8);
#define GRID_BAR() xcd_barrier(bar)
    const float* x = args.in[0]; const float* meta = args.in[1]; const float* conv_norm_g = args.in[2]; const float* conv_w_in = args.in[3]; const float* conv_w = args.in[4];
    const float* conv_w_out = args.in[5]; const float* kv_norm_g = args.in[6]; const float* w_kv = args.in[7]; const float* attn_norm_g = args.in[8]; const float* w_q = args.in[9];
    const float* w_o = args.in[10]; const float* sinks = args.in[11]; const float* ffn_norm_g = args.in[12]; const float* rg_w = args.in[13]; const float* rg_b = args.in[14];
    const float* re_w = args.in[15]; const float* re_b = args.in[16]; const float* w_gate = args.in[17]; const float* w_up = args.in[18]; const float* w_down = args.in[19]; const float* final_norm_g = args.in[20];
#define PHASE_PTRS() unsigned zoff_ = 0u; asm volatile("" : "+s"(zoff_)); unsigned char* wsl = ws + zoff_; int tid_p = threadIdx.x; asm volatile("" : "+v"(tid_p)); \
    Frame F; F.lds = (LAS unsigned char*)lds_raw; F.tid = tid_p; F.lane = tid_p & 63; F.wave = __builtin_amdgcn_readfirstlane(tid_p >> 6); F.G = G_; F.vcu = vcu_; \
    F.ws = wsl; F.ctl = (gu32*)(wsl + WS_CTL); F.out = args.out; F.HM = (float*)(wsl + WS_HM); \
    const int gw = F.vcu * 8 + F.wave, NGW = F.G * 8, gws = F.wave * F.G + F.vcu, lane = F.lane; (void)gw; (void)NGW; (void)gws; (void)lane; \
    float* rope = (float*)(wsl + WS_ROPE); bf16* WR = (bf16*)(wsl + WS_ROUTER); int* list = (int*)(wsl + WS_LIST); unsigned* pos = (unsigned*)(wsl + WS_POS); float* topw = (float*)(wsl + WS_TOPW); \
    bf16* Win_t = (bf16*)(wsl + WS_WIN); bf16* Wout_t = (bf16*)(wsl + WS_WOUT); bf16* Wqkv_t = (bf16*)(wsl + WS_WQKV); bf16* Wo_t = (bf16*)(wsl + WS_WO); \
    bf16* SA = (bf16*)(wsl + WS_SA); bf16* SB = (bf16*)(wsl + WS_SB); bf16* SC = (bf16*)(wsl + WS_SC); bf16* Kb = (bf16*)(wsl + WS_KV); bf16* Vb = (bf16*)(wsl + WS_KV + KV_BYTES); \
    bf16* Y = (bf16*)(wsl + WS_Y); bf16* HDN = (bf16*)(wsl + WS_HDN); \
    (void)rope; (void)WR; (void)list; (void)pos; (void)topw; (void)Win_t; (void)Wout_t; (void)Wqkv_t; (void)Wo_t; (void)SA; (void)SB; (void)SC; (void)Kb; (void)Vb; (void)Y; (void)HDN

    if (PHON(0)) { PHASE_PTRS();
        LAS unsigned* scr = (LAS unsigned*)(F.lds + F.wave * 16384);
        constexpr int I_IN = 16 * 48, I_OUT = 256, I_Q = 256, I_K = 16 * 4, I_V = 16 * 4, I_O = 256, I_DENSE = I_IN + I_OUT + I_Q + I_K + I_V + I_O, I_MOE = 2 * 32 * 192;
        for (int it = gw; it < I_DENSE + I_MOE; it += NGW) {
            int r = it;
            if (r < I_IN) { transpose_matrix_item(r, conv_w_in, 3 * D, 0, D, 3 * D, conv_norm_g, Win_t, 0, 0, scr, lane); continue; } r -= I_IN;
            if (r < I_OUT) { transpose_matrix_item(r, conv_w_out, D, 0, D, D, nullptr, Wout_t, 0, 0, scr, lane); continue; } r -= I_OUT;
            if (r < I_Q) { transpose_matrix_item(r, w_q, D, 0, D, D, attn_norm_g, Wqkv_t, 0, 1, scr, lane); continue; } r -= I_Q;
            if (r < I_K) { transpose_matrix_item(r, w_kv, 512, 0, D, 256, kv_norm_g, Wqkv_t, 1024, 1, scr, lane); continue; } r -= I_K;
            if (r < I_V) { transpose_matrix_item(r, w_kv, 512, 256, D, 256, kv_norm_g, Wqkv_t, 1280, 0, scr, lane); continue; } r -= I_V;
            if (r < I_O) { transpose_matrix_item(r, w_o, D, 0, D, D, nullptr, Wo_t, 0, 0, scr, lane); continue; } r -= I_O;
            const int le = r / 192, part = (r % 192) / 64, ti = r % 64, l = le >> 5;
            bf16* dst = (bf16*)(wsl + WS_WMOE + (size_t)l * WMOE_LAYER + (size_t)(le & 31) * WMOE_EXPERT + (size_t)part * WMOE_PART);
            if (part == 0) transpose_matrix_item(ti, w_gate + (size_t)le * D * FE, FE, 0, D, FE, ffn_norm_g + l * D, dst, 0, 0, scr, lane);
            else if (part == 1) transpose_matrix_item(ti, w_up + (size_t)le * D * FE, FE, 0, D, FE, ffn_norm_g + l * D, dst, 0, 0, scr, lane);
            else transpose_matrix_item(ti, w_down + (size_t)le * FE * D, D, 0, FE, D, nullptr, dst, 0, 0, scr, lane);
        }
        for (int m = gw; m < MR; m += NGW) rms_row_to_bf16(m < MX ? x + (size_t)m * D : meta + (size_t)(m - MX) * D, SA + (size_t)m * D, lane);
        const int gt = blockIdx.x * 512 + F.tid, NT = F.G * 512;
        for (int i = gt; i < 2 * 48 * D; i += NT) {
            const int l = i / (48 * D), c = (i / D) % 48, k = i % D; float w = 0.f;
            if (c < 4) w = rg_w[(size_t)l * D * 4 + k * 4 + c]; else if (c < 36) w = re_w[(size_t)l * D * 32 + k * 32 + (c - 4)];
            w *= ffn_norm_g[l * D + k]; const unsigned h = f2bf(w); const float lo = w - bf2f(h);
            WR[(size_t)l * 96 * D + (size_t)c * D + k] = (bf16)h; WR[(size_t)l * 96 * D + (size_t)(48 + c) * D + k] = (bf16)f2bf(lo);
        }
        for (int i = gt; i < LPOS * 32; i += NT) {
            const int p = i >> 5, j = i & 31; const double rev = (double)p * (double)args.inv_freq[j] * 0.15915494309189535; const float fr_ = (float)(rev - __builtin_rint(rev));
            rope[(size_t)p * 64 + j] = __builtin_amdgcn_cosf(fr_); rope[(size_t)p * 64 + 32 + j] = __builtin_amdgcn_sinf(fr_);
        }
        for (int i = gt; i < 2 * BATCH * 112 * 32; i += NT) {
            const int tns = i / (BATCH * 112 * 32), rem = i % (BATCH * 112 * 32), b = rem / (112 * 32), rr = (rem / 32) % 112, ch = rem % 32;
            *(u32x4*)((tns ? Vb : Kb) + ((size_t)b * KVROWS + rr) * 256 + ch * 8) = (u32x4){0u, 0u, 0u, 0u};
        }
    }
    GRID_BAR();

    if (PHON(1)) { PHASE_PTRS();
        if (gws < 128) {
            const bf16* A = SA + (size_t)MX * D; const int fr = lane & 15, fq = lane >> 4;
            if (gws < 64) { const bf16* const B[1] = {Win_t + (size_t)(16 * gws) * D}; f32x4 acc[1]; meta_mm<1>(A, B, D, acc, lane); store4bf(SB + (size_t)(MX + fr) * D + 16 * gws + 4 * fq, acc[0]); }
            else { const int jj = gws - 64; const bf16* const B[2] = {Win_t + (size_t)(1024 + 16 * jj) * D, Win_t + (size_t)(2048 + 16 * jj) * D}; f32x4 acc[2]; meta_mm<2>(A, B, D, acc, lane); store4bf(SC + (size_t)(MX + fr) * D + 16 * jj + 4 * fq, acc[0] * acc[1]); }
        }
        pg8::DenseSched<1> S{D, 12, F.G, (int)blockIdx.x};
        pg8::EpiIn E{SB, SC};
        pg8::gemm_phase<pg8::EpiIn, pg8::DenseSched<1>, true, false>(F.lds, D, (const char*)SA, (const char*)Win_t, nullptr, S, E);
    }
    GRID_BAR();

    if (PHON(2)) { PHASE_PTRS();
        const float* cw = conv_w;
        for (int row = gw; row < MR; row += NGW) {
            int r1, r2;
            if (row < MX) { const int s = row & (SEQ - 1); r1 = s >= 1 ? row - 1 : MX + 15; r2 = s >= 2 ? row - 2 : (s == 1 ? MX + 15 : MX + 14); }
            else { const int i = row - MX; r1 = i >= 1 ? row - 1 : -1; r2 = i >= 2 ? row - 2 : -1; }
#pragma unroll
            for (int j = 0; j < 2; ++j) {
                const int c0 = 8 * lane + 512 * j;
                const u32x4 gbv = *(const u32x4*)(SB + (size_t)row * D + c0), u0 = *(const u32x4*)(SC + (size_t)row * D + c0);
                const u32x4 u1 = r1 >= 0 ? *(const u32x4*)(SC + (size_t)r1 * D + c0) : (u32x4){0u, 0u, 0u, 0u}, u2 = r2 >= 0 ? *(const u32x4*)(SC + (size_t)r2 * D + c0) : (u32x4){0u, 0u, 0u, 0u};
                const f32x4 w0a = *(const f32x4*)(cw + c0), w0b = *(const f32x4*)(cw + c0 + 4), w1a = *(const f32x4*)(cw + D + c0), w1b = *(const f32x4*)(cw + D + c0 + 4), w2a = *(const f32x4*)(cw + 2 * D + c0), w2b = *(const f32x4*)(cw + 2 * D + c0 + 4);
                u32x4 o;
#pragma unroll
                for (int q = 0; q < 4; ++q) {
                    const float x0 = q < 2 ? w0a[2 * (q & 1)] : w0b[2 * (q & 1)], x0h = q < 2 ? w0a[2 * (q & 1) + 1] : w0b[2 * (q & 1) + 1];
                    const float x1 = q < 2 ? w1a[2 * (q & 1)] : w1b[2 * (q & 1)], x1h = q < 2 ? w1a[2 * (q & 1) + 1] : w1b[2 * (q & 1) + 1];
                    const float x2 = q < 2 ? w2a[2 * (q & 1)] : w2b[2 * (q & 1)], x2h = q < 2 ? w2a[2 * (q & 1) + 1] : w2b[2 * (q & 1) + 1];
                    const float ca = x0 * bf2f(u2[q] & 0xffffu) + x1 * bf2f(u1[q] & 0xffffu) + x2 * bf2f(u0[q] & 0xffffu);
                    const float cb = x0h * bf2f(u2[q] >> 16) + x1h * bf2f(u1[q] >> 16) + x2h * bf2f(u0[q] >> 16);
                    o[q] = pk2(bf2f(gbv[q] & 0xffffu) * ca, bf2f(gbv[q] >> 16) * cb);
                }
                *(u32x4*)(SA + (size_t)row * D + c0) = o;
            }
        }
    }
    GRID_BAR();

    if (PHON(3)) { PHASE_PTRS();
        if (gws < 64) { const bf16* A = SA + (size_t)MX * D; const int fr = lane & 15, fq = lane >> 4; const bf16* const B[1] = {Wout_t + (size_t)(16 * gws) * D}; f32x4 acc[1]; meta_mm<1>(A, B, D, acc, lane);
            const size_t o = (size_t)fr * D + 16 * gws + 4 * fq; *(f32x4*)(F.HM + o) = *(const f32x4*)(meta + o) + acc[0]; }
        pg8::DenseSched<0> S{D, 4, F.G, (int)blockIdx.x};
        pg8::EpiRes E{x, F.out};
        pg8::gemm_phase<pg8::EpiRes, pg8::DenseSched<0>, false, false>(F.lds, D, (const char*)SA, (const char*)Wout_t, nullptr, S, E);
    }
    GRID_BAR();

    for (int layer = 0; layer < 2; ++layer) {
        const int nrows = layer == 0 ? MR : MX;
        unsigned* cnt = (unsigned*)(ctl + CW_CNT) + layer * 32 * 64;
        if (PHON(4)) { PHASE_PTRS(); router_phase(F, nrows, WR + (size_t)layer * 96 * D, rg_b + layer * 4, re_b + layer * 32, cnt, list, pos, topw, SA); }
        GRID_BAR();
        { PHASE_PTRS(); build_tile_table(F, cnt); }
        if (PHON(5)) { PHASE_PTRS();
            pg8::MoeSched1 S{(const volatile LAS int*)(F.lds + TILETAB_OFF), F.G, F.vcu};
            pg8::EpiHdn E{HDN};
            pg8::gemm_phase<pg8::EpiHdn, pg8::MoeSched1, true, true>(F.lds, D, (const char*)SA, (const char*)(wsl + WS_WMOE + (size_t)layer * WMOE_LAYER), list, S, E);
        }
        GRID_BAR();
        if (PHON(6)) { PHASE_PTRS();
            pg8::MoeSched2 S{(const volatile LAS int*)(F.lds + TILETAB_OFF), F.G, F.vcu};
            pg8::EpiY E{Y};
            pg8::gemm_phase<pg8::EpiY, pg8::MoeSched2, true, false>(F.lds, FE, (const char*)HDN, (const char*)(wsl + WS_WMOE + (size_t)layer * WMOE_LAYER), nullptr, S, E);
        }
        GRID_BAR();
        if (layer == 0) {
            if (PHON(7)) { PHASE_PTRS(); combine_phase<false>(F, MR, Y, pos, topw, SA, nullptr); }
            GRID_BAR();
            if (PHON(8)) { PHASE_PTRS();
                if (gws < 24) {
                    const bf16* A = SA + (size_t)MX * D; const int fr = lane & 15, fq = lane >> 4;
                    if (gws < 8) { const int kvh = gws >> 1, db = gws & 1; const bf16* const B[2] = {Wqkv_t + (size_t)(1024 + 32 * kvh + 16 * db) * D, Wqkv_t + (size_t)(1024 + 128 + 32 * kvh + 16 * db) * D};
                        f32x4 acc[2]; meta_mm<2>(A, B, D, acc, lane);
                        const int d = 16 * db + 4 * fq; const f32x4 c = *(const f32x4*)(rope + (size_t)fr * 64 + d), sn = *(const f32x4*)(rope + (size_t)fr * 64 + 32 + d);
                        const f32x4 o1 = acc[0] * c - acc[1] * sn, o2 = acc[1] * c + acc[0] * sn;
                        for (int b = 0; b < BATCH; ++b) { bf16* dst = Kb + ((size_t)b * KVROWS + 112 + fr) * 256 + kvh * 64 + d; store4bf(dst, o1); store4bf(dst + 32, o2); } }
                    else { const int c0 = 16 * (gws - 8); const bf16* const B[1] = {Wqkv_t + (size_t)(1280 + c0) * D}; f32x4 acc[1]; meta_mm<1>(A, B, D, acc, lane);
                        for (int b = 0; b < BATCH; ++b) store4bf(Vb + ((size_t)b * KVROWS + 112 + fr) * 256 + c0 + 4 * fq, acc[0]); }
                }
                pg8::DenseSched<0> S{D, 6, F.G, (int)blockIdx.x};
                pg8::EpiQKV E{SB, Kb, Vb, rope};
                pg8::gemm_phase<pg8::EpiQKV, pg8::DenseSched<0>, true, false>(F.lds, D, (const char*)SA, (const char*)Wqkv_t, nullptr, S, E);
            }
            GRID_BAR();
            if (PHON(9)) { PHASE_PTRS(); attn_phase(F, SB, Kb, Vb, SC, sinks); }
            GRID_BAR();
            if (PHON(10)) { PHASE_PTRS();
                pg8::DenseSched<0> S{D, 4, F.G, (int)blockIdx.x};
                pg8::EpiRes E{F.out, F.out};
                pg8::gemm_phase<pg8::EpiRes, pg8::DenseSched<0>, false, false>(F.lds, D, (const char*)SC, (const char*)Wo_t, nullptr, S, E);
            }
            GRID_BAR();
        } else {
            if (PHON(11)) { PHASE_PTRS(); combine_phase<true>(F, MX, Y, pos, topw, nullptr, final_norm_g); }
        }
    }
#undef GRID_BAR
}

extern "C" void kernel_launch(void* const* d_in, const int* in_sizes, int n_in, void* d_out, int out_size, void* d_ws, size_t ws_size, hipStream_t stream) {
    static int grid = 0;
    if (grid == 0) {
        if (n_in != 21 || in_sizes[0] != MX * D || out_size != MX * D || ws_size < WS_END) { fprintf(stderr, "kernel_launch: unexpected shapes / workspace (n_in %d, in0 %d, out %d, ws %zu)\n", n_in, n_in > 0 ? in_sizes[0] : -1, out_size, ws_size); grid = -1; return; }
        int dev = 0, cus = 0;
        if (hipGetDevice(&dev) != hipSuccess || hipDeviceGetAttribute(&cus, hipDeviceAttributeMultiprocessorCount, dev) != hipSuccess) { grid = -1; return; }
        if (hipFuncSetAttribute((const void*)yoco_fwd, hipFuncAttributeMaxDynamicSharedMemorySize, LDS_BYTES) != hipSuccess) { fprintf(stderr, "kernel_launch: hipFuncSetAttribute failed\n"); grid = -1; return; }
        (void)hipGetLastError();
        grid = cus;
    }
    if (grid < 0) return;
    if (hipMemsetAsync((char*)d_ws + WS_CTL, 0, CTL_ZERO_BYTES, stream) != hipSuccess) return;
    Args a{};
    for (int i = 0; i < 21; ++i) a.in[i] = (const float*)d_in[i];
    a.out = (float*)d_out; a.ws = (unsigned char*)d_ws;
    for (int i = 0; i < 32; ++i) a.inv_freq[i] = (float)pow(10000.0, -(double)i / 32.0);
    hipLaunchKernelGGL(yoco_fwd, dim3(grid), dim3(512), LDS_BYTES, stream, a);
}
```
